# Optimizing an MI355X kernel written in HIP

```python
import math
import jax, jax.numpy as jnp
from jax import lax
import numpy as np

D_MODEL = 1024
BATCH = 8
SEQ = 2048
DEPTH = 2

CHUNK = 64
Q_BLOCK = 128
N_MIXERS = 2
ATTN_HEADS = 8
ATTN_HEAD_DIM = 64
SSM_GROUP = 16
SSM_GROUPS = D_MODEL // SSM_GROUP
SSM_STATE = 64
D_FF = 2816
ALPHA = (2 * DEPTH) ** 0.25
BETA = (8 * DEPTH) ** -0.25
N_ATTN_LAYERS = (DEPTH + 1) // 2
N_SSM_LAYERS = DEPTH // 2
LN_EPS = 1e-5
DT_MIN = 1e-3
DT_MAX = 1e-1

kernel_name = "hybrid_diffattn_s5_macaron_deepnorm_adaln"


def layer_norm(x, g, b):
    xf = x.astype(jnp.float32)
    mu = jnp.mean(xf, axis=-1, keepdims=True)
    var = jnp.mean(jnp.square(xf - mu), axis=-1, keepdims=True)
    y = (xf - mu) * lax.rsqrt(var + LN_EPS) * g.astype(jnp.float32) + b.astype(jnp.float32)
    return y.astype(x.dtype)


def modulate(x, shift, scale):
    return x * (1.0 + scale[:, None, :]) + shift[:, None, :]


def post_norm_residual(x, y, gate, g, b):
    return layer_norm(ALPHA * x + gate[:, None, :] * y, g, b)


def swiglu(h, w1, w3, w2):
    return (jax.nn.silu(h @ w1) * (h @ w3)) @ w2


def diff_attention(h, w_in, lam, subln_g, w_out, lam_init):
    bsz, seq, _ = h.shape
    hd = ATTN_HEAD_DIM
    q, k, v = jnp.split(h @ w_in, 3, axis=-1)
    q = q.reshape(bsz, seq, ATTN_HEADS, 2, hd)
    k = k.reshape(bsz, seq, ATTN_HEADS, 2, hd)
    v = v.reshape(bsz, seq, ATTN_HEADS, 2 * hd)
    lam_f = lam.astype(jnp.float32)
    lam_full = (jnp.exp(jnp.sum(lam_f[0] * lam_f[1]))
                - jnp.exp(jnp.sum(lam_f[2] * lam_f[3])) + lam_init)
    scale = hd ** -0.5
    outs = []
    for s0 in range(0, seq, Q_BLOCK):
        kend = s0 + Q_BLOCK
        scores = jnp.einsum('bqhmd,bkhmd->bhmqk', q[:, s0:kend], k[:, :kend])
        scores = scores.astype(jnp.float32) * scale
        q_chunk = (s0 + jnp.arange(Q_BLOCK)) // CHUNK
        k_chunk = jnp.arange(kend) // CHUNK
        allowed = k_chunk[None, :] <= q_chunk[:, None]
        scores = jnp.where(allowed, scores, -jnp.inf)
        p = jax.nn.softmax(scores, axis=-1)
        attn = p[:, :, 0] - lam_full * p[:, :, 1]
        outs.append(jnp.einsum('bhqk,bkhe->bqhe', attn.astype(v.dtype), v[:, :kend]))
    o = jnp.concatenate(outs, axis=1).astype(jnp.float32)
    o = o * lax.rsqrt(jnp.mean(jnp.square(o), axis=-1, keepdims=True) + LN_EPS)
    o = o * subln_g.astype(jnp.float32) * (1.0 - lam_init)
    return o.astype(h.dtype).reshape(bsz, seq, ATTN_HEADS * 2 * hd) @ w_out


def _complex_affine_combine(e1, e2):
    a1r, a1i, b1r, b1i = e1
    a2r, a2i, b2r, b2i = e2
    ar = a1r * a2r - a1i * a2i
    ai = a1r * a2i + a1i * a2r
    br = a2r * b1r - a2i * b1i + b2r
    bi = a2r * b1i + a2i * b1r + b2i
    return (ar, ai, br, bi)


def s5_scan(u, a_re, a_im, log_dt, b_re, b_im, c_re, c_im):
    bsz, seq, g, p = u.shape
    n_chunks = seq // CHUNK
    f32 = jnp.float32
    a_re, a_im = a_re.astype(f32), a_im.astype(f32)
    b_re, b_im = b_re.astype(f32), b_im.astype(f32)
    c_re, c_im = c_re.astype(f32), c_im.astype(f32)
    dt = jnp.exp(log_dt.astype(f32))[:, None]
    mag = jnp.exp(a_re * dt)
    abar_re, abar_im = mag * jnp.cos(a_im * dt), mag * jnp.sin(a_im * dt)
    den = a_re * a_re + a_im * a_im
    pr, pi_ = abar_re - 1.0, abar_im
    coef_re = (pr * a_re + pi_ * a_im) / den
    coef_im = (pi_ * a_re - pr * a_im) / den
    bbar_re = coef_re[..., None] * b_re - coef_im[..., None] * b_im
    bbar_im = coef_re[..., None] * b_im + coef_im[..., None] * b_re
    steps = jnp.arange(1, CHUNK + 1, dtype=f32)[:, None, None]
    pmag = jnp.exp(a_re[None] * dt[None] * steps)
    pow_re = pmag * jnp.cos(a_im[None] * dt[None] * steps)
    pow_im = pmag * jnp.sin(a_im[None] * dt[None] * steps)
    a_b_re = jnp.broadcast_to(abar_re, (CHUNK, bsz, g, SSM_STATE))
    a_b_im = jnp.broadcast_to(abar_im, (CHUNK, bsz, g, SSM_STATE))
    uc = u.reshape(bsz, n_chunks, CHUNK, g, p).transpose(1, 2, 0, 3, 4)

    def step(carry, u_chunk):
        h_re, h_im = carry
        bu_re = jnp.einsum('lbgp,gnp->lbgn', u_chunk, bbar_re)
        bu_im = jnp.einsum('lbgp,gnp->lbgn', u_chunk, bbar_im)
        _, _, s_re, s_im = lax.associative_scan(
            _complex_affine_combine, (a_b_re, a_b_im, bu_re, bu_im), axis=0)
        hr = s_re + pow_re[:, None] * h_re[None] - pow_im[:, None] * h_im[None]
        hi = s_im + pow_re[:, None] * h_im[None] + pow_im[:, None] * h_re[None]
        y = (jnp.einsum('lbgn,gpn->lbgp', hr, c_re)
             - jnp.einsum('lbgn,gpn->lbgp', hi, c_im))
        return (hr[-1], hi[-1]), y

    init = (jnp.zeros((bsz, g, SSM_STATE), f32), jnp.zeros((bsz, g, SSM_STATE), f32))
    _, ys = lax.scan(step, init, uc)
    return ys.transpose(2, 0, 1, 3, 4).reshape(bsz, seq, g, p)


def s5_mixer(h, w_in, a_re, a_im, log_dt, b_re, b_im, c_re, c_im, d, w_gate, w_out):
    bsz, seq, _ = h.shape
    u = (h @ w_in).reshape(bsz, seq, SSM_GROUPS, SSM_GROUP).astype(jnp.float32)
    y = s5_scan(u, a_re, a_im, log_dt, b_re, b_im, c_re, c_im) + d.astype(jnp.float32) * u
    z = jax.nn.gelu(y.reshape(bsz, seq, D_MODEL)).astype(h.dtype)
    z = z * jax.nn.sigmoid(z @ w_gate)
    return z @ w_out


def setup_inputs(seed: int = 0) -> dict:
    key = jax.random.key(seed)
    ks = iter(jax.random.split(key, 32))
    f32 = jnp.float32
    D, F = D_MODEL, D_FF
    NA, NS, G, N, P = N_ATTN_LAYERS, N_SSM_LAYERS, SSM_GROUPS, SSM_STATE, SSM_GROUP
    nrm = lambda shape, std: std * jax.random.normal(next(ks), shape, f32)
    x = nrm((BATCH, SEQ, D), 1.0)
    c = nrm((BATCH, D), 1.0)
    ada_w = nrm((DEPTH, D, 9 * D), 0.5 * D ** -0.5)
    ada_b = nrm((DEPTH, 9 * D), 0.01)
    ln_g = 1.0 + nrm((DEPTH, 3, D), 0.02)
    ln_b = nrm((DEPTH, 3, D), 0.02)
    ffn_w1 = nrm((DEPTH, 2, D, F), D ** -0.5)
    ffn_w3 = nrm((DEPTH, 2, D, F), D ** -0.5)
    ffn_w2 = nrm((DEPTH, 2, F, D), BETA * F ** -0.5)
    qk = nrm((NA, D, 2 * D), D ** -0.5)
    vv = nrm((NA, D, D), BETA * D ** -0.5)
    attn_w_in = jnp.concatenate([qk, vv], axis=-1)
    attn_lam = nrm((NA, 4, ATTN_HEAD_DIM), 0.1)
    attn_subln_g = 1.0 + nrm((NA, 2 * ATTN_HEAD_DIM), 0.02)
    attn_w_out = nrm((NA, D, D), BETA * D ** -0.5)
    ssm_w_in = nrm((NS, D, D), D ** -0.5)
    ssm_a_re = -0.5 + nrm((NS, G, N), 0.01)
    ssm_a_im = math.pi * jnp.arange(N, dtype=f32)[None, None, :] + nrm((NS, G, N), 0.01)
    ssm_log_dt = jax.random.uniform(next(ks), (NS, G), f32,
                                    minval=math.log(DT_MIN), maxval=math.log(DT_MAX))
    ssm_b_re = nrm((NS, G, N, P), (2 * P) ** -0.5)
    ssm_b_im = nrm((NS, G, N, P), (2 * P) ** -0.5)
    ssm_c_re = nrm((NS, G, P, N), (2 * N) ** -0.5)
    ssm_c_im = nrm((NS, G, P, N), (2 * N) ** -0.5)
    ssm_d = nrm((NS, G, P), 1.0)
    ssm_w_gate = nrm((NS, D, D), D ** -0.5)
    ssm_w_out = nrm((NS, D, D), BETA * D ** -0.5)
    return {"x": x, "c": c, "ada_w": ada_w, "ada_b": ada_b, "ln_g": ln_g, "ln_b": ln_b,
            "ffn_w1": ffn_w1, "ffn_w3": ffn_w3, "ffn_w2": ffn_w2,
            "attn_w_in": attn_w_in, "attn_lam": attn_lam, "attn_subln_g": attn_subln_g,
            "attn_w_out": attn_w_out, "ssm_w_in": ssm_w_in, "ssm_a_re": ssm_a_re,
            "ssm_a_im": ssm_a_im, "ssm_log_dt": ssm_log_dt, "ssm_b_re": ssm_b_re,
            "ssm_b_im": ssm_b_im, "ssm_c_re": ssm_c_re, "ssm_c_im": ssm_c_im,
            "ssm_d": ssm_d, "ssm_w_gate": ssm_w_gate, "ssm_w_out": ssm_w_out}


def reference(x, c, ada_w, ada_b, ln_g, ln_b, ffn_w1, ffn_w3, ffn_w2,
              attn_w_in, attn_lam, attn_subln_g, attn_w_out,
              ssm_w_in, ssm_a_re, ssm_a_im, ssm_log_dt, ssm_b_re, ssm_b_im,
              ssm_c_re, ssm_c_im, ssm_d, ssm_w_gate, ssm_w_out):
    bsz = x.shape[0]
    cond = jax.nn.silu(c)
    for layer in range(DEPTH):
        mods = (cond @ ada_w[layer] + ada_b[layer]).reshape(bsz, 3, 3, D_MODEL)
        shift, scale, gate = mods[:, :, 0], mods[:, :, 1], 1.0 + mods[:, :, 2]
        h = modulate(x, shift[:, 0], scale[:, 0])
        y = 0.5 * swiglu(h, ffn_w1[layer, 0], ffn_w3[layer, 0], ffn_w2[layer, 0])
        x = post_norm_residual(x, y, gate[:, 0], ln_g[layer, 0], ln_b[layer, 0])
        h = modulate(x, shift[:, 1], scale[:, 1])
        i = layer // N_MIXERS
        if layer % N_MIXERS == 0:
            lam_init = 0.8 - 0.6 * math.exp(-0.3 * layer)
            y = diff_attention(h, attn_w_in[i], attn_lam[i], attn_subln_g[i],
                               attn_w_out[i], lam_init)
        else:
            y = s5_mixer(h, ssm_w_in[i], ssm_a_re[i], ssm_a_im[i], ssm_log_dt[i],
                         ssm_b_re[i], ssm_b_im[i], ssm_c_re[i], ssm_c_im[i], ssm_d[i],
                         ssm_w_gate[i], ssm_w_out[i])
        x = post_norm_residual(x, y, gate[:, 1], ln_g[layer, 1], ln_b[layer, 1])
        h = modulate(x, shift[:, 2], scale[:, 2])
        y = 0.5 * swiglu(h, ffn_w1[layer, 1], ffn_w3[layer, 1], ffn_w2[layer, 1])
        x = post_norm_residual(x, y, gate[:, 2], ln_g[layer, 2], ln_b[layer, 2])
    return x
```

```cpp
#include <hip/hip_runtime.h>
#include <cstdio>
#include <cstdint>
#include <cmath>

namespace {
constexpr int D = 1024, BATCH = 8, SEQ = 2048, M = BATCH * SEQ, F = 2816, DEPTH = 2;
constexpr int HEADS = 8, HD = 64, G = 64, P = 16, NS = 64;
constexpr float LN_EPS = 1e-5f;
constexpr float ALPHA = 1.4142135623730951f;

__device__ __forceinline__ float wave_sum(float v) {
#pragma unroll
    for (int o = 1; o < 64; o <<= 1) v += __shfl_xor(v, o);
    return v;
}
__device__ __forceinline__ float silu_f(float v) { return v / (1.f + __expf(-v)); }
__device__ __forceinline__ float gelu_tanh(float v) { const float u = 0.7978845608028654f * (v + 0.044715f * v * v * v); return 0.5f * v * (1.f + tanhf(u)); }

__global__ void __launch_bounds__(256) k_mods(const float* __restrict__ c, const float* __restrict__ ada_w, const float* __restrict__ ada_b, float* __restrict__ mods) {
    __shared__ float sc[D];
    const int l = blockIdx.z, b = blockIdx.y, col = blockIdx.x * 256 + threadIdx.x;
    for (int k = threadIdx.x; k < D; k += 256) sc[k] = silu_f(c[b * D + k]);
    __syncthreads();
    const float* w = ada_w + (size_t)l * D * 9 * D + col;
    float acc = 0.f;
    for (int k = 0; k < D; ++k) acc += sc[k] * w[(size_t)k * 9 * D];
    mods[((size_t)l * BATCH + b) * 9 * D + col] = acc + ada_b[(size_t)l * 9 * D + col];
}

__global__ void __launch_bounds__(256) k_modulate(const float* __restrict__ x, const float* __restrict__ modsl, int sub, float* __restrict__ h) {
    const size_t i = (size_t)blockIdx.x * 256 + threadIdx.x;
    const int row = (int)(i / (D / 4)), d4 = (int)(i % (D / 4)), b = row / SEQ;
    const float4 xv = ((const float4*)x)[i];
    const float* mb = modsl + (size_t)b * 9 * D + sub * 3 * D;
    const float4 sh = ((const float4*)mb)[d4], sc = ((const float4*)(mb + D))[d4];
    float4 o; o.x = xv.x * (1.f + sc.x) + sh.x; o.y = xv.y * (1.f + sc.y) + sh.y; o.z = xv.z * (1.f + sc.z) + sh.z; o.w = xv.w * (1.f + sc.w) + sh.w;
    ((float4*)h)[i] = o;
}

__global__ void __launch_bounds__(256) k_postnorm(const float* xin, const float* __restrict__ y, float ymul, const float* __restrict__ modsl, int sub,
                                                   const float* __restrict__ g, const float* __restrict__ bta, float* xout) {
    const int row = blockIdx.x * 4 + (threadIdx.x >> 6), lane = threadIdx.x & 63, b = row / SEQ;
    const float* gate = modsl + (size_t)b * 9 * D + sub * 3 * D + 2 * D;
    float v[16]; float s = 0.f;
#pragma unroll
    for (int j = 0; j < 4; ++j) {
        const int d = j * 256 + lane * 4;
        const float4 xv = *(const float4*)(xin + (size_t)row * D + d), yv = *(const float4*)(y + (size_t)row * D + d), gv = *(const float4*)(gate + d);
        v[4 * j + 0] = ALPHA * xv.x + (1.f + gv.x) * ymul * yv.x; v[4 * j + 1] = ALPHA * xv.y + (1.f + gv.y) * ymul * yv.y;
        v[4 * j + 2] = ALPHA * xv.z + (1.f + gv.z) * ymul * yv.z; v[4 * j + 3] = ALPHA * xv.w + (1.f + gv.w) * ymul * yv.w;
        s += (v[4 * j] + v[4 * j + 1]) + (v[4 * j + 2] + v[4 * j + 3]);
    }
    const float mean = wave_sum(s) * (1.f / D); float q = 0.f;
#pragma unroll
    for (int i = 0; i < 16; ++i) { v[i] -= mean; q += v[i] * v[i]; }
    const float rstd = 1.f / sqrtf(wave_sum(q) * (1.f / D) + LN_EPS);
#pragma unroll
    for (int j = 0; j < 4; ++j) {
        const int d = j * 256 + lane * 4;
        const float4 gv = *(const float4*)(g + d), bv = *(const float4*)(bta + d);
        float4 o; o.x = v[4 * j] * rstd * gv.x + bv.x; o.y = v[4 * j + 1] * rstd * gv.y + bv.y; o.z = v[4 * j + 2] * rstd * gv.z + bv.z; o.w = v[4 * j + 3] * rstd * gv.w + bv.w;
        *(float4*)(xout + (size_t)row * D + d) = o;
    }
}

template <int MODE>
__global__ void __launch_bounds__(256) k_gemm(const float* __restrict__ A, int lda, const float* __restrict__ B0, const float* __restrict__ B1, int ldb,
                                               float* __restrict__ C, int ldc, int K, const float* __restrict__ Z) {
    __shared__ float As[8][132];
    __shared__ float Bs[2][8][64];
    const int tid = threadIdx.x, tx = tid & 15, ty = tid >> 4;
    const int row0 = blockIdx.y * 128;
    const int c0 = (MODE == 1) ? blockIdx.x * 64 : blockIdx.x * 128;
    const float* bp0 = B0 + c0; const float* bp1 = (MODE == 1) ? B1 + c0 : B0 + c0 + 64;
    float acc0[8][4], acc1[8][4];
#pragma unroll
    for (int i = 0; i < 8; ++i)
#pragma unroll
        for (int j = 0; j < 4; ++j) { acc0[i][j] = 0.f; acc1[i][j] = 0.f; }
    const int ar = tid >> 1, ak = (tid & 1) * 4;
    const int bw = tid >> 7, bk = (tid & 127) >> 4, bc = (tid & 15) * 4;
    for (int k0 = 0; k0 < K; k0 += 8) {
        const float4 av = *(const float4*)(A + (size_t)(row0 + ar) * lda + k0 + ak);
        const float4 bv = *(const float4*)((bw ? bp1 : bp0) + (size_t)(k0 + bk) * ldb + bc);
        __syncthreads();
        As[ak + 0][ar] = av.x; As[ak + 1][ar] = av.y; As[ak + 2][ar] = av.z; As[ak + 3][ar] = av.w;
        *(float4*)&Bs[bw][bk][bc] = bv;
        __syncthreads();
#pragma unroll
        for (int kk = 0; kk < 8; ++kk) {
            float a[8], b0[4], b1[4];
            const float4 a0 = *(const float4*)&As[kk][ty * 8], a1 = *(const float4*)&As[kk][ty * 8 + 4];
            a[0] = a0.x; a[1] = a0.y; a[2] = a0.z; a[3] = a0.w; a[4] = a1.x; a[5] = a1.y; a[6] = a1.z; a[7] = a1.w;
            const float4 q0 = *(const float4*)&Bs[0][kk][tx * 4], q1 = *(const float4*)&Bs[1][kk][tx * 4];
            b0[0] = q0.x; b0[1] = q0.y; b0[2] = q0.z; b0[3] = q0.w; b1[0] = q1.x; b1[1] = q1.y; b1[2] = q1.z; b1[3] = q1.w;
#pragma unroll
            for (int i = 0; i < 8; ++i)
#pragma unroll
                for (int j = 0; j < 4; ++j) { acc0[i][j] += a[i] * b0[j]; acc1[i][j] += a[i] * b1[j]; }
        }
    }
#pragma unroll
    for (int i = 0; i < 8; ++i) {
        const int row = row0 + ty * 8 + i;
        if (MODE == 0) {
            float4 o0 = {acc0[i][0], acc0[i][1], acc0[i][2], acc0[i][3]}, o1 = {acc1[i][0], acc1[i][1], acc1[i][2], acc1[i][3]};
            *(float4*)(C + (size_t)row * ldc + c0 + tx * 4) = o0;
            *(float4*)(C + (size_t)row * ldc + c0 + 64 + tx * 4) = o1;
        } else if (MODE == 1) {
            float4 o; o.x = silu_f(acc0[i][0]) * acc1[i][0]; o.y = silu_f(acc0[i][1]) * acc1[i][1]; o.z = silu_f(acc0[i][2]) * acc1[i][2]; o.w = silu_f(acc0[i][3]) * acc1[i][3];
            *(float4*)(C + (size_t)row * ldc + c0 + tx * 4) = o;
        } else {
            const float4 z0 = *(const float4*)(Z + (size_t)row * ldc + c0 + tx * 4), z1 = *(const float4*)(Z + (size_t)row * ldc + c0 + 64 + tx * 4);
            float4 o0, o1;
            o0.x = z0.x / (1.f + __expf(-acc0[i][0])); o0.y = z0.y / (1.f + __expf(-acc0[i][1])); o0.z = z0.z / (1.f + __expf(-acc0[i][2])); o0.w = z0.w / (1.f + __expf(-acc0[i][3]));
            o1.x = z1.x / (1.f + __expf(-acc1[i][0])); o1.y = z1.y / (1.f + __expf(-acc1[i][1])); o1.z = z1.z / (1.f + __expf(-acc1[i][2])); o1.w = z1.w / (1.f + __expf(-acc1[i][3]));
            *(float4*)(C + (size_t)row * ldc + c0 + tx * 4) = o0;
            *(float4*)(C + (size_t)row * ldc + c0 + 64 + tx * 4) = o1;
        }
    }
}

__global__ void __launch_bounds__(256) k_attn(const float* __restrict__ qkv, const float* __restrict__ lam, float lam_init, float* __restrict__ out) {
    const int qc = blockIdx.x, h = blockIdx.y, b = blockIdx.z;
    const int r = threadIdx.x & 63, quarter = __builtin_amdgcn_readfirstlane(threadIdx.x >> 6);
    float l1 = 0.f, l2 = 0.f;
    for (int i = 0; i < HD; ++i) { l1 += lam[i] * lam[HD + i]; l2 += lam[2 * HD + i] * lam[3 * HD + i]; }
    const float lam_full = __expf(l1) - __expf(l2) + lam_init;
    const size_t rowq = (size_t)b * SEQ + qc * 64 + r;
    const int nkeys = (qc + 1) * 64;
    float res[32];
    for (int mp = 0; mp < 2; ++mp) {
        float q[64];
        const float* qp = qkv + rowq * 3072 + h * 128 + mp * 64;
#pragma unroll
        for (int i = 0; i < 64; i += 4) { const float4 t = *(const float4*)(qp + i); q[i] = t.x * 0.125f; q[i + 1] = t.y * 0.125f; q[i + 2] = t.z * 0.125f; q[i + 3] = t.w * 0.125f; }
        float o[32];
#pragma unroll
        for (int i = 0; i < 32; ++i) o[i] = 0.f;
        float mx = -1e30f, l = 0.f;
        const float* kbase = qkv + (size_t)b * SEQ * 3072 + 1024 + h * 128 + mp * 64;
        const float* vbase = qkv + (size_t)b * SEQ * 3072 + 2048 + h * 128 + quarter * 32;
        for (int k = 0; k < nkeys; ++k) {
            const float* kp = kbase + (size_t)k * 3072;
            float s = 0.f;
#pragma unroll
            for (int i = 0; i < 64; ++i) s += q[i] * kp[i];
            const float mn = fmaxf(mx, s), f = __expf(mx - mn), p = __expf(s - mn);
            mx = mn; l = l * f + p;
            const float* vp = vbase + (size_t)k * 3072;
#pragma unroll
            for (int i = 0; i < 32; ++i) o[i] = o[i] * f + p * vp[i];
        }
        const float il = 1.f / l;
        if (mp == 0) {
#pragma unroll
            for (int i = 0; i < 32; ++i) res[i] = o[i] * il;
        } else {
#pragma unroll
            for (int i = 0; i < 32; ++i) res[i] -= lam_full * o[i] * il;
        }
    }
    float* op = out + rowq * D + h * 128 + quarter * 32;
#pragma unroll
    for (int i = 0; i < 32; i += 4) { float4 t = {res[i], res[i + 1], res[i + 2], res[i + 3]}; *(float4*)(op + i) = t; }
}

__global__ void __launch_bounds__(256) k_subln(float* __restrict__ o, const float* __restrict__ g, float mul) {
    const size_t wv = (size_t)blockIdx.x * 4 + (threadIdx.x >> 6); const int lane = threadIdx.x & 63;
    float* p = o + wv * 128 + lane * 2;
    const float a = p[0], c = p[1];
    const float ss = wave_sum(a * a + c * c);
    const float r = 1.f / sqrtf(ss * (1.f / 128.f) + LN_EPS);
    p[0] = a * r * g[lane * 2] * mul; p[1] = c * r * g[lane * 2 + 1] * mul;
}

__global__ void __launch_bounds__(64) k_scan(const float* __restrict__ u, const float* __restrict__ a_re, const float* __restrict__ a_im, const float* __restrict__ log_dt,
                                              const float* __restrict__ b_re, const float* __restrict__ b_im, const float* __restrict__ c_re, const float* __restrict__ c_im,
                                              const float* __restrict__ dd, float* __restrict__ z) {
    const int g = blockIdx.x, b = blockIdx.y, n = threadIdx.x;
    const float dt = expf(log_dt[g]);
    const float are = a_re[g * NS + n], aim = a_im[g * NS + n];
    const float mag = expf(are * dt), abr = mag * cosf(aim * dt), abi = mag * sinf(aim * dt);
    const float den = are * are + aim * aim, pr = abr - 1.f, pi = abi;
    const float cfr = (pr * are + pi * aim) / den, cfi = (pi * are - pr * aim) / den;
    float bbr[16], bbi[16], cr[16], ci[16];
#pragma unroll
    for (int p = 0; p < 16; ++p) {
        const float br = b_re[((size_t)g * NS + n) * P + p], bi = b_im[((size_t)g * NS + n) * P + p];
        bbr[p] = cfr * br - cfi * bi; bbi[p] = cfr * bi + cfi * br;
        cr[p] = c_re[((size_t)g * P + p) * NS + n]; ci[p] = c_im[((size_t)g * P + p) * NS + n];
    }
    const float dmy = (n < 16) ? dd[g * P + n] : 0.f;
    float hr = 0.f, hi = 0.f;
    const float* up = u + (size_t)b * SEQ * D + g * P;
    float* zp = z + (size_t)b * SEQ * D + g * P;
    for (int t = 0; t < SEQ; ++t) {
        float uv[16];
#pragma unroll
        for (int p = 0; p < 16; p += 4) { const float4 t4 = *(const float4*)(up + (size_t)t * D + p); uv[p] = t4.x; uv[p + 1] = t4.y; uv[p + 2] = t4.z; uv[p + 3] = t4.w; }
        float bur = 0.f, bui = 0.f;
#pragma unroll
        for (int p = 0; p < 16; ++p) { bur += bbr[p] * uv[p]; bui += bbi[p] * uv[p]; }
        const float nhr = abr * hr - abi * hi + bur, nhi = abr * hi + abi * hr + bui;
        hr = nhr; hi = nhi;
        float mine = 0.f, myu = 0.f;
#pragma unroll
        for (int p = 0; p < 16; ++p) {
            const float s = wave_sum(cr[p] * hr - ci[p] * hi);
            if (n == p) { mine = s; myu = uv[p]; }
        }
        if (n < 16) zp[(size_t)t * D + n] = gelu_tanh(mine + dmy * myu);
    }
}
}

extern "C" void kernel_launch(void* const* d_in, const int* in_sizes, int n_in, void* d_out, int out_size, void* d_ws, size_t ws_size, hipStream_t stream) {
    const float* x = (const float*)d_in[0]; const float* c = (const float*)d_in[1]; const float* ada_w = (const float*)d_in[2]; const float* ada_b = (const float*)d_in[3];
    const float* ln_g = (const float*)d_in[4]; const float* ln_b = (const float*)d_in[5];
    const float* w1 = (const float*)d_in[6]; const float* w3 = (const float*)d_in[7]; const float* w2 = (const float*)d_in[8];
    const float* attn_w_in = (const float*)d_in[9]; const float* attn_lam = (const float*)d_in[10]; const float* subln_g = (const float*)d_in[11]; const float* attn_w_out = (const float*)d_in[12];
    const float* ssm_w_in = (const float*)d_in[13]; const float* a_re = (const float*)d_in[14]; const float* a_im = (const float*)d_in[15]; const float* log_dt = (const float*)d_in[16];
    const float* b_re = (const float*)d_in[17]; const float* b_im = (const float*)d_in[18]; const float* c_re = (const float*)d_in[19]; const float* c_im = (const float*)d_in[20];
    const float* ssm_d = (const float*)d_in[21]; const float* w_gate = (const float*)d_in[22]; const float* ssm_w_out = (const float*)d_in[23];
    float* xb = (float*)d_out;
    char* ws = (char*)d_ws;
    float* mods = (float*)ws;
    float* R1 = (float*)(ws + (4u << 20));
    float* R2 = (float*)(ws + (68u << 20));
    float* R2b = R2 + (size_t)M * D;

    k_mods<<<dim3(9 * D / 256, BATCH, DEPTH), 256, 0, stream>>>(c, ada_w, ada_b, mods);
    for (int layer = 0; layer < DEPTH; ++layer) {
        const float* ml = mods + (size_t)layer * BATCH * 9 * D;
        const float* xin = (layer == 0) ? x : xb;
        k_modulate<<<M * D / 4 / 256, 256, 0, stream>>>(xin, ml, 0, R1);
        k_gemm<1><<<dim3(F / 64, M / 128), 256, 0, stream>>>(R1, D, w1 + (size_t)(layer * 2 + 0) * D * F, w3 + (size_t)(layer * 2 + 0) * D * F, F, R2, F, D, nullptr);
        k_gemm<0><<<dim3(D / 128, M / 128), 256, 0, stream>>>(R2, F, w2 + (size_t)(layer * 2 + 0) * F * D, nullptr, D, R1, D, F, nullptr);
        k_postnorm<<<M / 4, 256, 0, stream>>>(xin, R1, 0.5f, ml, 0, ln_g + (layer * 3 + 0) * D, ln_b + (layer * 3 + 0) * D, xb);
        k_modulate<<<M * D / 4 / 256, 256, 0, stream>>>(xb, ml, 1, R1);
        if (layer % 2 == 0) {
            const float lam_init = 0.8f - 0.6f * expf(-0.3f * (float)layer);
            k_gemm<0><<<dim3(3 * D / 128, M / 128), 256, 0, stream>>>(R1, D, attn_w_in, nullptr, 3 * D, R2, 3 * D, D, nullptr);
            k_attn<<<dim3(SEQ / 64, HEADS, BATCH), 256, 0, stream>>>(R2, attn_lam, lam_init, R1);
            k_subln<<<M * HEADS / 4, 256, 0, stream>>>(R1, subln_g, 1.f - lam_init);
            k_gemm<0><<<dim3(D / 128, M / 128), 256, 0, stream>>>(R1, D, attn_w_out, nullptr, D, R2, D, D, nullptr);
            k_postnorm<<<M / 4, 256, 0, stream>>>(xb, R2, 1.0f, ml, 1, ln_g + (layer * 3 + 1) * D, ln_b + (layer * 3 + 1) * D, xb);
        } else {
            k_gemm<0><<<dim3(D / 128, M / 128), 256, 0, stream>>>(R1, D, ssm_w_in, nullptr, D, R2, D, D, nullptr);
            k_scan<<<dim3(G, BATCH), 64, 0, stream>>>(R2, a_re, a_im, log_dt, b_re, b_im, c_re, c_im, ssm_d, R1);
            k_gemm<2><<<dim3(D / 128, M / 128), 256, 0, stream>>>(R1, D, w_gate, nullptr, D, R2b, D, D, R1);
            k_gemm<0><<<dim3(D / 128, M / 128), 256, 0, stream>>>(R2b, D, ssm_w_out, nullptr, D, R2, D, D, nullptr);
            k_postnorm<<<M / 4, 256, 0, stream>>>(xb, R2, 1.0f, ml, 1, ln_g + (layer * 3 + 1) * D, ln_b + (layer * 3 + 1) * D, xb);
        }
        k_modulate<<<M * D / 4 / 256, 256, 0, stream>>>(xb, ml, 2, R1);
        k_gemm<1><<<dim3(F / 64, M / 128), 256, 0, stream>>>(R1, D, w1 + (size_t)(layer * 2 + 1) * D * F, w3 + (size_t)(layer * 2 + 1) * D * F, F, R2, F, D, nullptr);
        k_gemm<0><<<dim3(D / 128, M / 128), 256, 0, stream>>>(R2, F, w2 + (size_t)(layer * 2 + 1) * F * D, nullptr, D, R1, D, F, nullptr);
        k_postnorm<<<M / 4, 256, 0, stream>>>(xb, R1, 0.5f, ml, 2, ln_g + (layer * 3 + 2) * D, ln_b + (layer * 3 + 2) * D, xb);
    }
}
```
